# Optimizing an MI355X kernel written in HIP

```python
import math
import numpy as np
import jax
import jax.numpy as jnp
from jax import lax

D_MODEL = 2048
BATCH = 16
SEQ = 2048
DEPTH = 1

GLA_HEADS = 4
GLA_KW = D_MODEL // 2
GLA_VW = D_MODEL
GLA_DK = GLA_KW // GLA_HEADS
GLA_DV = GLA_VW // GLA_HEADS
GATE_RANK = 16
GATE_NORM = 16.0
CHUNK = 64
CONV_W = D_MODEL
CONV_K = 3
FFN_HIDDEN = 4 * D_MODEL
EPS = 1e-6

kernel_name = "hybrid_gla_shortconv_gated_merge"

_WIDTHS = (GLA_KW, GLA_KW, GLA_VW, GLA_VW, GATE_RANK, CONV_W, CONV_W, CONV_W, D_MODEL, D_MODEL)
IN_COLS = GLA_KW * 2 + GLA_VW * 2 + GATE_RANK + CONV_W * 3 + D_MODEL * 2


def rms_norm(x, g):
    xf = x.astype(jnp.float32)
    y = xf * lax.rsqrt(jnp.mean(xf * xf, axis=-1, keepdims=True) + EPS)
    return (y * g.astype(jnp.float32)).astype(x.dtype)


def _to_chunks(t):
    b, s, h, d = t.shape
    return jnp.transpose(t.reshape(b, s // CHUNK, CHUNK, h, d), (1, 0, 3, 2, 4))


def gla_chunked(q, k, v, log_a):
    b, s, h, dv = v.shape
    dk = q.shape[-1]
    qc = _to_chunks(q.astype(jnp.float32) * (dk ** -0.5))
    kc = _to_chunks(k.astype(jnp.float32))
    vc = _to_chunks(v.astype(jnp.float32))
    gc = _to_chunks(log_a.astype(jnp.float32))
    causal = jnp.tril(jnp.ones((CHUNK, CHUNK), dtype=bool))

    def step(state, inp):
        q_c, k_c, v_c, g_c = inp
        cum = jnp.cumsum(g_c, axis=2)
        last = cum[:, :, -1:, :]
        inter = jnp.einsum('bhtd,bhde->bhte', q_c * jnp.exp(cum), state)
        diff = cum[:, :, :, None, :] - cum[:, :, None, :, :]
        decay = jnp.exp(jnp.where(causal[None, None, :, :, None], diff, -jnp.inf))
        scores = jnp.einsum('bhtd,bhsd,bhtsd->bhts', q_c, k_c, decay)
        intra = jnp.einsum('bhts,bhse->bhte', scores, v_c)
        new_state = state * jnp.exp(last[:, :, 0, :, None]) + jnp.einsum(
            'bhcd,bhce->bhde', k_c * jnp.exp(last - cum), v_c)
        return new_state, inter + intra

    state0 = jnp.zeros((b, h, dk, dv), jnp.float32)
    _, out = lax.scan(step, state0, (qc, kc, vc, gc))
    return jnp.transpose(out, (1, 0, 3, 2, 4)).reshape(b, s, h, dv)


def causal_depthwise_conv(u, w):
    c = u.shape[-1]
    return lax.conv_general_dilated(
        u, w.reshape(CONV_K, 1, c).astype(u.dtype), window_strides=(1,),
        padding=((CONV_K - 1, 0),), dimension_numbers=('NWC', 'WIO', 'NWC'),
        feature_group_count=c)


def setup_inputs(seed: int = 0) -> dict:
    key = jax.random.key(seed)
    ks = jax.random.split(key, 20)
    n = jax.random.normal
    f = jnp.float32
    return {
        "x": n(ks[0], (BATCH, SEQ, D_MODEL), f),
        "g_mix": 1.0 + 0.02 * n(ks[1], (DEPTH, D_MODEL), f),
        "w_in": n(ks[2], (DEPTH, D_MODEL, IN_COLS), f) * D_MODEL ** -0.5,
        "w_gate_up": n(ks[3], (DEPTH, GATE_RANK, GLA_KW), f) * GATE_RANK ** -0.5,
        "b_gate": 0.02 * n(ks[4], (DEPTH, GLA_KW), f),
        "g_gla_norm": 1.0 + 0.02 * n(ks[5], (DEPTH, GLA_DV), f),
        "w_gla_out": n(ks[6], (DEPTH, GLA_VW, D_MODEL), f) * GLA_VW ** -0.5,
        "conv_w": n(ks[7], (DEPTH, CONV_K, CONV_W), f) * CONV_K ** -0.5,
        "w_conv_out": n(ks[8], (DEPTH, CONV_W, D_MODEL), f) * CONV_W ** -0.5,
        "w_o": n(ks[9], (DEPTH, D_MODEL, D_MODEL), f) * D_MODEL ** -0.5,
        "g_ffn": 1.0 + 0.02 * n(ks[10], (DEPTH, D_MODEL), f),
        "w_ffn_up": n(ks[11], (DEPTH, D_MODEL, FFN_HIDDEN), f) * D_MODEL ** -0.5,
        "w_ffn_down": n(ks[12], (DEPTH, FFN_HIDDEN, D_MODEL), f) * FFN_HIDDEN ** -0.5,
        "g_final": 1.0 + 0.02 * n(ks[13], (D_MODEL,), f),
    }


def reference(x, g_mix, w_in, w_gate_up, b_gate, g_gla_norm, w_gla_out, conv_w,
              w_conv_out, w_o, g_ffn, w_ffn_up, w_ffn_down, g_final):
    b, s, _ = x.shape
    splits = np.cumsum(_WIDTHS)[:-1].tolist()
    for l in range(DEPTH):
        h = rms_norm(x, g_mix[l])
        proj = jnp.einsum('bsd,dn->bsn', h, w_in[l])
        (q, k, v, r, lr, cb, cc, cx, ga, gb) = jnp.split(proj, splits, axis=-1)

        gate_pre = jnp.einsum('bsr,rk->bsk', lr, w_gate_up[l]) + b_gate[l]
        log_a = jax.nn.log_sigmoid(gate_pre.astype(jnp.float32)) / GATE_NORM
        o = gla_chunked(q.reshape(b, s, GLA_HEADS, GLA_DK),
                        k.reshape(b, s, GLA_HEADS, GLA_DK),
                        v.reshape(b, s, GLA_HEADS, GLA_DV),
                        log_a.reshape(b, s, GLA_HEADS, GLA_DK))
        o = rms_norm(o, g_gla_norm[l]).reshape(b, s, GLA_VW).astype(x.dtype)
        y_a = jnp.einsum('bse,ed->bsd', o * jax.nn.silu(r), w_gla_out[l])

        u = causal_depthwise_conv(cc * cx, conv_w[l])
        y_b = jnp.einsum('bsc,cd->bsd', cb * u, w_conv_out[l])

        merged = jax.nn.sigmoid(ga) * y_a + jax.nn.sigmoid(gb) * y_b
        x = x + jnp.einsum('bsd,de->bse', merged, w_o[l])

        h2 = rms_norm(x, g_ffn[l])
        hid = jnp.square(jax.nn.relu(jnp.einsum('bsd,df->bsf', h2, w_ffn_up[l])))
        x = x + jnp.einsum('bsf,fd->bsd', hid, w_ffn_down[l])
    return rms_norm(x, g_final)
```

```cpp
#include <hip/hip_runtime.h>
#include <hip/hip_cooperative_groups.h>
#include <cstdio>
namespace cg = cooperative_groups;

#define LAS __attribute__((address_space(3)))
typedef unsigned short bf16_t;
typedef short bf16x8 __attribute__((ext_vector_type(8)));
typedef short s16x4 __attribute__((ext_vector_type(4)));
typedef float f32x4 __attribute__((ext_vector_type(4)));
typedef float f32x2 __attribute__((ext_vector_type(2)));
typedef unsigned u32x4 __attribute__((ext_vector_type(4)));
typedef unsigned u32x2 __attribute__((ext_vector_type(2)));
typedef __bf16 bf16x2_t __attribute__((ext_vector_type(2)));

#ifndef MK_SPLIT
#define MK_SPLIT 0
#endif

constexpr int M_ = 32768, D_ = 2048, KW_ = 1024, FF_ = 8192, SEQ_ = 2048;
constexpr int INC_ = 16400;
constexpr int NIN_ = 17408;
constexpr float EPS_ = 1e-6f;
constexpr int SC_LR = 6144, SC_CB = 6160, SC_CC = 8208, SC_CX = 10256, SC_GA = 12304, SC_GB = 14352;

constexpr size_t MiB = (size_t)1 << 20;
constexpr size_t WS_WIN = 1 * MiB, WS_WGLA = 69 * MiB, WS_WCONV = 77 * MiB, WS_WO = 85 * MiB, WS_WUP = 93 * MiB, WS_WDOWN = 125 * MiB;
constexpr size_t WS_SS = 157 * MiB;
constexpr size_t WS_H = 160 * MiB;
constexpr size_t WS_Q = 288 * MiB, WS_K = 352 * MiB, WS_V = 416 * MiB, WS_R = 544 * MiB, WS_G = 672 * MiB, WS_CB = 736 * MiB, WS_P = 864 * MiB;
constexpr size_t WS_MG = 288 * MiB;
constexpr size_t WS_HID = 288 * MiB;
constexpr size_t WS_NEED = 992 * MiB;
constexpr int LDS_BYTES = 139264;

__device__ __forceinline__ unsigned cvtpk(float lo, float hi) { f32x2 v = {lo, hi}; bf16x2_t b = __builtin_convertvector(v, bf16x2_t); return __builtin_bit_cast(unsigned, b); }
__device__ __forceinline__ float bflo(unsigned w) { return __uint_as_float(w << 16); }
__device__ __forceinline__ float bfhi(unsigned w) { return __uint_as_float(w & 0xffff0000u); }
__device__ __forceinline__ float wave_sum(float v) {
#pragma unroll
    for (int o = 1; o < 64; o <<= 1) v += __shfl_xor(v, o);
    return v;
}
__device__ __forceinline__ float act(int mode, float x) {
    switch (mode) {
        case 1: return x * 0.0625f;
        case 2: return x * __builtin_amdgcn_rcpf(1.f + __expf(-x));
        case 3: return __builtin_amdgcn_rcpf(1.f + __expf(-x));
        case 4: return (fminf(x, 0.f) - __logf(1.f + __expf(-fabsf(x)))) * (0.0625f * 1.4426950408889634f);
        case 5: { const float r = fmaxf(x, 0.f); return r * r; }
        default: return x;
    }
}

namespace pg8 {
constexpr int BM = 256, BK = 64, HALF = 128, HTB = HALF * BK * 2, STAGE_BYTES = 8 * HTB, NXCD = 8, WGM = 8;
__device__ __forceinline__ int lds_byte(int r, int c) { const int st = (r >> 4) * 2 + (c >> 5), rr = r & 15, cc = c & 31, ob = rr * 64 + cc * 2; return st * 1024 + (ob ^ (((ob >> 9) & 1) << 5)); }
__device__ __forceinline__ void stage_rc(int b, int& R, int& C) { const int st = b / 1024, sb = b % 1024, swz = sb ^ (((sb >> 9) & 1) << 5); R = (st >> 1) * 16 + swz / 64; C = (st & 1) * 32 + (swz % 64) / 2; }
__device__ __forceinline__ int perm32(int rho) { const int n = rho >> 4, i = rho & 15; return 8 * (i >> 2) + 4 * n + (i & 3); }

struct Unit { int pm, pn, part; };
struct Gemm { const bf16_t* A; const bf16_t* Bt; const bf16_t* A2; const bf16_t* Bt2; int K; };
struct TileOrder {
    int nM, nN, nwg, G, c, parts;
    __device__ void init(int M, int N, int G_, int c_, int parts_) { nM = M / BM; nN = N / BM; nwg = nM * nN; G = G_; c = c_; parts = parts_; }
    __device__ bool next(int i, Unit& u) const {
        const int ti = (parts == 2) ? (i >> 1) : i; u.part = (parts == 2) ? (i & 1) : 0;
        const long L = (long)ti * G + c; if (L >= nwg) return false;
        int wgid = (int)L; { const int q = nwg / NXCD, r = nwg % NXCD, xcd = wgid % NXCD, off = wgid / NXCD; wgid = (xcd < r ? xcd * (q + 1) : r * (q + 1) + (xcd - r) * q) + off; }
        const int nig = WGM * nN, gid = wgid / nig, fm = gid * WGM, gsz = (nM - fm) < WGM ? (nM - fm) : WGM;
        u.pm = fm + ((wgid % nig) % gsz); u.pn = (wgid % nig) / gsz; return true;
    }
};

template <class Epi>
__device__ __forceinline__ void gemm_phase(LAS unsigned char* lds, const Gemm g, const TileOrder& S, const Epi& E) {
    const int tid = threadIdx.x, wid = __builtin_amdgcn_readfirstlane(tid >> 6), lane = tid & 63, wr = wid >> 2, wc = wid & 3, fr = lane & 15, fq = lane >> 4;
    const int K = g.K, nt = K / BK;
    unsigned voffA[2], voffB[2];
#pragma unroll
    for (int i = 0; i < 2; ++i) { int R, C; stage_rc(tid * 16 + i * 8192, R, C); const int Rb = Epi::PERM ? ((R & ~31) + perm32(R & 31)) : R;
        voffA[i] = (unsigned)(R * K + C) * 2u; voffB[i] = (unsigned)(Rb * K + C) * 2u; }
    const size_t kstep = (size_t)(BK * 2);
    const size_t hstep = (size_t)HALF * K * 2;
    const size_t tstep = 2 * hstep;
    const unsigned ldsw = (unsigned)wid * 1024u;
    const int aoff = lds_byte(wr * 64 + fr, fq * 8), boff = lds_byte(wc * 32 + fr, fq * 8);
#define PG8_SA(b, h) (((b) * 2 + (h)) * HTB)
#define PG8_SB(b, h) ((4 + (b) * 2 + (h)) * HTB)
#define PG8_STAGE(bufoff, gbase, voff) do { _Pragma("unroll") for (int _i = 0; _i < 2; ++_i) \
        __builtin_amdgcn_global_load_lds((const unsigned*)((const char*)(gbase) + (voff)[_i]), (LAS unsigned*)(lds + (bufoff) + ldsw + _i * 8192), 16, 0, 0); } while (0)
#define PG8_LDA(dst, b, h) do { _Pragma("unroll") for (int m = 0; m < 4; ++m) _Pragma("unroll") for (int k = 0; k < 2; ++k) dst[m][k] = *(const LAS bf16x8*)(lds + PG8_SA(b, h) + aoff + m * 2048 + k * 1024); } while (0)
#define PG8_LDB(dst, b, h) do { _Pragma("unroll") for (int n = 0; n < 2; ++n) _Pragma("unroll") for (int k = 0; k < 2; ++k) dst[n][k] = *(const LAS bf16x8*)(lds + PG8_SB(b, h) + boff + n * 2048 + k * 1024); } while (0)
#define PG8_MMA(ai, bj, At, Bt) do { __builtin_amdgcn_s_setprio(1); _Pragma("unroll") for (int m = 0; m < 4; ++m) _Pragma("unroll") for (int n = 0; n < 2; ++n) _Pragma("unroll") for (int k = 0; k < 2; ++k) \
        acc[ai][bj][m][n] = __builtin_amdgcn_mfma_f32_16x16x32_bf16(Bt[n][k], At[m][k], acc[ai][bj][m][n], 0, 0, 0); __builtin_amdgcn_s_setprio(0); } while (0)
#define PG8_WAIT_V(n) asm volatile("s_waitcnt vmcnt(" #n ")" ::: "memory")
#define PG8_WAIT_L(n) asm volatile("s_waitcnt lgkmcnt(" #n ")" ::: "memory")
#define PG8_BAR __builtin_amdgcn_s_barrier()
#define PG8_SCHED __builtin_amdgcn_sched_barrier(0)
#define PG8_UA(u) ((const char*)((u).part ? g.A2 : g.A) + (size_t)(u).pm * tstep)
#define PG8_UB(u) ((const char*)((u).part ? g.Bt2 : g.Bt) + (size_t)(u).pn * tstep)
    Unit cur, nxt; int ui = 0;
    if (!S.next(0, cur)) return;
    f32x4 acc[2][2][4][2];
#pragma unroll
    for (int a = 0; a < 2; ++a)
#pragma unroll
        for (int b = 0; b < 2; ++b)
#pragma unroll
            for (int m = 0; m < 4; ++m)
#pragma unroll
                for (int n = 0; n < 2; ++n) acc[a][b][m][n] = (f32x4){0.f, 0.f, 0.f, 0.f};
    bf16x8 At[4][2], B0[2][2], B1[2][2];
    const char* cA = PG8_UA(cur); const char* cB = PG8_UB(cur);
    PG8_STAGE(PG8_SB(0, 0), cB, voffB); PG8_STAGE(PG8_SA(0, 0), cA, voffA); PG8_STAGE(PG8_SB(0, 1), cB + hstep, voffB); PG8_STAGE(PG8_SA(0, 1), cA + hstep, voffA);
    if (wr == 1) PG8_BAR;
    PG8_WAIT_V(4); PG8_BAR;
    PG8_STAGE(PG8_SB(1, 0), cB + kstep, voffB); PG8_STAGE(PG8_SA(1, 0), cA + kstep, voffA); PG8_STAGE(PG8_SB(1, 1), cB + hstep + kstep, voffB);
    PG8_WAIT_V(6); PG8_BAR;
    for (;;) {
        const bool has_next = S.next(ui + 1, nxt);
        const char* nA = has_next ? PG8_UA(nxt) : cA; const char* nB = has_next ? PG8_UB(nxt) : cB;
        for (int t = 0; t < nt; t += 2) {
            const bool last = (t == nt - 2);
            const char* a1 = cA + (size_t)(t + 1) * kstep;
            const char* a2 = last ? nA : cA + (size_t)(t + 2) * kstep; const char* b2 = last ? nB : cB + (size_t)(t + 2) * kstep;
            const char* a3 = a2 + kstep; const char* b3 = b2 + kstep;
            PG8_LDB(B0, 0, 0); PG8_SCHED; PG8_LDA(At, 0, 0); PG8_STAGE(PG8_SA(1, 1), a1 + hstep, voffA);
            PG8_WAIT_L(8); PG8_BAR; PG8_WAIT_L(0); PG8_MMA(0, 0, At, B0); PG8_BAR; PG8_SCHED;
            PG8_LDB(B1, 0, 1); PG8_STAGE(PG8_SB(0, 0), b2, voffB);
            PG8_BAR; PG8_WAIT_L(0); PG8_MMA(0, 1, At, B1); PG8_BAR;
            PG8_LDA(At, 0, 1); PG8_STAGE(PG8_SA(0, 0), a2, voffA);
            PG8_BAR; PG8_WAIT_L(0); PG8_MMA(1, 0, At, B0); PG8_BAR; PG8_SCHED;
            PG8_STAGE(PG8_SB(0, 1), b2 + hstep, voffB);
            PG8_WAIT_V(6); PG8_BAR; PG8_MMA(1, 1, At, B1); PG8_BAR;
            PG8_LDB(B0, 1, 0); PG8_SCHED; PG8_LDA(At, 1, 0); PG8_STAGE(PG8_SA(0, 1), a2 + hstep, voffA);
            PG8_WAIT_L(8); PG8_BAR; PG8_WAIT_L(0); PG8_MMA(0, 0, At, B0); PG8_BAR; PG8_SCHED;
            PG8_LDB(B1, 1, 1); PG8_STAGE(PG8_SB(1, 0), b3, voffB);
            PG8_BAR; PG8_WAIT_L(0); PG8_MMA(0, 1, At, B1); PG8_BAR;
            PG8_LDA(At, 1, 1); PG8_STAGE(PG8_SA(1, 0), a3, voffA);
            PG8_BAR; PG8_WAIT_L(0); PG8_MMA(1, 0, At, B0); PG8_BAR; PG8_SCHED;
            PG8_STAGE(PG8_SB(1, 1), b3 + hstep, voffB);
            PG8_WAIT_V(6); PG8_BAR; PG8_MMA(1, 1, At, B1); PG8_BAR;
        }
        E(acc, cur, wr, wc, fr, fq);
        if (!has_next) break;
        if (!E.keep(cur)) {
#pragma unroll
            for (int a = 0; a < 2; ++a)
#pragma unroll
                for (int b = 0; b < 2; ++b)
#pragma unroll
                    for (int m = 0; m < 4; ++m)
#pragma unroll
                        for (int n = 0; n < 2; ++n) acc[a][b][m][n] = (f32x4){0.f, 0.f, 0.f, 0.f};
        }
        cur = nxt; cA = nA; cB = nB; ++ui;
    }
    PG8_WAIT_V(0);
    if (wr == 0) PG8_BAR;
    PG8_BAR;
#undef PG8_SA
#undef PG8_SB
#undef PG8_STAGE
#undef PG8_LDA
#undef PG8_LDB
#undef PG8_MMA
#undef PG8_WAIT_V
#undef PG8_WAIT_L
#undef PG8_BAR
#undef PG8_SCHED
#undef PG8_UA
#undef PG8_UB
}

typedef f32x4 Acc[2][2][4][2];

__device__ __forceinline__ void store_bf16_tile(const Acc& acc, bf16_t* base, int ldc, int colt, int row0, int wc, int fq, int mode, const float* bias) {
    const int col0 = colt + wc * 32 + 8 * fq;
    f32x4 bv[2][2];
#pragma unroll
    for (int bj = 0; bj < 2; ++bj)
#pragma unroll
        for (int n = 0; n < 2; ++n) bv[bj][n] = bias ? *(const f32x4*)(bias + col0 + bj * HALF + 4 * n) : (f32x4){0.f, 0.f, 0.f, 0.f};
#pragma unroll
    for (int ai = 0; ai < 2; ++ai)
#pragma unroll
        for (int m = 0; m < 4; ++m) { bf16_t* rowp = base + (size_t)(row0 + ai * HALF + m * 16) * ldc + col0;
#pragma unroll
            for (int bj = 0; bj < 2; ++bj) { f32x4 v0 = acc[ai][bj][m][0] + bv[bj][0], v1 = acc[ai][bj][m][1] + bv[bj][1];
#pragma unroll
                for (int j = 0; j < 4; ++j) { v0[j] = act(mode, v0[j]); v1[j] = act(mode, v1[j]); }
                u32x4 w; w.x = cvtpk(v0[0], v0[1]); w.y = cvtpk(v0[2], v0[3]); w.z = cvtpk(v1[0], v1[1]); w.w = cvtpk(v1[2], v1[3]);
                *(u32x4*)(rowp + bj * HALF) = w; } }
}

struct EpiIn {
    static constexpr bool PERM = true;
    bf16_t *Q, *Kk, *V, *R, *G, *CB, *P, *GA, *GB; const float* bgate;
    __device__ __forceinline__ bool keep(const Unit&) const { return false; }
    __device__ __forceinline__ void operator()(const Acc& acc, const Unit& u, int wr, int wc, int fr, int fq) const {
        const int pn = u.pn, row0 = u.pm * BM + wr * 64 + fr;
        if (pn >= 36 && pn < 52) {
            const int col0 = (pn - 36) * 128 + wc * 32 + 8 * fq;
#pragma unroll
            for (int ai = 0; ai < 2; ++ai)
#pragma unroll
                for (int m = 0; m < 4; ++m) { const f32x4 v0 = acc[ai][0][m][0] * acc[ai][1][m][0], v1 = acc[ai][0][m][1] * acc[ai][1][m][1];
                    u32x4 w; w.x = cvtpk(v0[0], v0[1]); w.y = cvtpk(v0[2], v0[3]); w.z = cvtpk(v1[0], v1[1]); w.w = cvtpk(v1[2], v1[3]);
                    *(u32x4*)(P + (size_t)(row0 + ai * HALF + m * 16) * D_ + col0) = w; }
            return;
        }
        bf16_t* base; int ldc, colt, mode; const float* bias = nullptr;
        if (pn < 4)       { base = Q;  ldc = KW_; colt = pn * 256;        mode = 1; }
        else if (pn < 8)  { base = Kk; ldc = KW_; colt = (pn - 4) * 256;  mode = 0; }
        else if (pn < 16) { base = V;  ldc = D_;  colt = (pn - 8) * 256;  mode = 0; }
        else if (pn < 24) { base = R;  ldc = D_;  colt = (pn - 16) * 256; mode = 2; }
        else if (pn < 28) { base = G;  ldc = KW_; colt = (pn - 24) * 256; mode = 4; bias = bgate; }
        else if (pn < 36) { base = CB; ldc = D_;  colt = (pn - 28) * 256; mode = 0; }
        else if (pn < 60) { base = GA; ldc = D_;  colt = (pn - 52) * 256; mode = 3; }
        else              { base = GB; ldc = D_;  colt = (pn - 60) * 256; mode = 3; }
        store_bf16_tile(acc, base, ldc, colt, row0, wc, fq, mode, bias);
    }
};

struct EpiDual {
    static constexpr bool PERM = true;
    const bf16_t *GA, *GB; bf16_t* MG;
    __device__ __forceinline__ bool keep(const Unit& u) const { return u.part == 0; }
    __device__ __forceinline__ void operator()(Acc& acc, const Unit& u, int wr, int wc, int fr, int fq) const {
        const int row0 = u.pm * BM + wr * 64 + fr, col0 = u.pn * BM + wc * 32 + 8 * fq;
#pragma unroll
        for (int ai = 0; ai < 2; ++ai)
#pragma unroll
            for (int m = 0; m < 4; ++m) { const size_t off = (size_t)(row0 + ai * HALF + m * 16) * D_ + col0;
#pragma unroll
                for (int bj = 0; bj < 2; ++bj) {
                    const u32x4 gb = *(const u32x4*)(GB + off + bj * HALF);
                    f32x4 b0 = {bflo(gb.x), bfhi(gb.x), bflo(gb.y), bfhi(gb.y)}, b1 = {bflo(gb.z), bfhi(gb.z), bflo(gb.w), bfhi(gb.w)};
                    if (u.part == 0) {
                        const u32x4 ga = *(const u32x4*)(GA + off + bj * HALF);
                        const f32x4 a0 = {bflo(ga.x), bfhi(ga.x), bflo(ga.y), bfhi(ga.y)}, a1 = {bflo(ga.z), bfhi(ga.z), bflo(ga.w), bfhi(ga.w)};
#pragma unroll
                        for (int j = 0; j < 4; ++j) { acc[ai][bj][m][0][j] *= a0[j] * __builtin_amdgcn_rcpf(b0[j]); acc[ai][bj][m][1][j] *= a1[j] * __builtin_amdgcn_rcpf(b1[j]); }
                    } else {
                        const f32x4 v0 = acc[ai][bj][m][0] * b0, v1 = acc[ai][bj][m][1] * b1;
                        u32x4 w; w.x = cvtpk(v0[0], v0[1]); w.y = cvtpk(v0[2], v0[3]); w.z = cvtpk(v1[0], v1[1]); w.w = cvtpk(v1[2], v1[3]);
                        *(u32x4*)(MG + off + bj * HALF) = w;
                    } } }
    }
};

struct EpiRes {
    static constexpr bool PERM = false;
    const float* base; float* out;
    __device__ __forceinline__ bool keep(const Unit&) const { return false; }
    __device__ __forceinline__ void operator()(const Acc& acc, const Unit& u, int wr, int wc, int fr, int fq) const {
        const int row0 = u.pm * BM + wr * 64 + fr, col0 = u.pn * BM + wc * 32 + 4 * fq;
#pragma unroll
        for (int ai = 0; ai < 2; ++ai)
#pragma unroll
            for (int m = 0; m < 4; ++m) { const size_t off = (size_t)(row0 + ai * HALF + m * 16) * D_ + col0;
#pragma unroll
                for (int bj = 0; bj < 2; ++bj)
#pragma unroll
                    for (int n = 0; n < 2; ++n) { const f32x4 bs = *(const f32x4*)(base + off + bj * HALF + n * 16); *(f32x4*)(out + off + bj * HALF + n * 16) = bs + acc[ai][bj][m][n]; }
                asm volatile("" ::: "memory"); }
    }
};

struct EpiUp {
    static constexpr bool PERM = true;
    bf16_t* HID;
    __device__ __forceinline__ bool keep(const Unit&) const { return false; }
    __device__ __forceinline__ void operator()(const Acc& acc, const Unit& u, int wr, int wc, int fr, int fq) const {
        store_bf16_tile(acc, HID, FF_, u.pn * BM, u.pm * BM + wr * 64 + fr, wc, fq, 5, nullptr);
    }
};
}

__device__ __forceinline__ void transpose_item(const float* W, int ldw, int src_col, bf16_t* WT, int K, int dst_row, int k0, LAS float* scr, int lane) {
#pragma unroll 8
    for (int i = 0; i < 32; ++i) { const int kk = 2 * i + (lane >> 5); scr[kk * 33 + (lane & 31)] = W[(size_t)(k0 + kk) * ldw + src_col + (lane & 31)]; }
    asm volatile("s_waitcnt lgkmcnt(0)" ::: "memory");
    const int c = lane & 7;
#pragma unroll
    for (int j = 0; j < 4; ++j) { const int n = (lane >> 3) + 8 * j; const LAS float* s = scr + (8 * c) * 33 + n;
        u32x4 o; o.x = cvtpk(s[0 * 33], s[1 * 33]); o.y = cvtpk(s[2 * 33], s[3 * 33]); o.z = cvtpk(s[4 * 33], s[5 * 33]); o.w = cvtpk(s[6 * 33], s[7 * 33]);
        *(u32x4*)(WT + (size_t)(dst_row + n) * K + k0 + 8 * c) = o; }
    asm volatile("s_waitcnt lgkmcnt(0)" ::: "memory");
}
__device__ __forceinline__ int win_src_col(int n0) {
    if (n0 < 6144) return n0;
    if (n0 < 7168) return -1;
    if (n0 < 9216) return SC_CB + (n0 - 7168);
    if (n0 < 13312) { const int o = n0 - 9216, j = o >> 8, r = o & 255; return r < 128 ? SC_CC + 128 * j + r : SC_CX + 128 * j + (r - 128); }
    if (n0 < 15360) return SC_GA + (n0 - 13312);
    return SC_GB + (n0 - 15360);
}
__device__ __forceinline__ void rms_row_bf16(const float* xrow, const float* g, bf16_t* orow, int lane) {
    const f32x4* xr = (const f32x4*)xrow + lane;
    f32x4 v[8]; float s = 0.f;
#pragma unroll
    for (int j = 0; j < 8; ++j) { v[j] = xr[64 * j]; s += (v[j].x * v[j].x + v[j].y * v[j].y) + (v[j].z * v[j].z + v[j].w * v[j].w); }
    const float rs = 1.0f / sqrtf(wave_sum(s) * (1.f / D_) + EPS_);
    const f32x4* gr = (const f32x4*)g + lane;
    u32x2* o8 = (u32x2*)orow + lane;
#pragma unroll
    for (int j = 0; j < 8; ++j) { const f32x4 gg = gr[64 * j]; u32x2 w; w.x = cvtpk(v[j].x * rs * gg.x, v[j].y * rs * gg.y); w.y = cvtpk(v[j].z * rs * gg.z, v[j].w * rs * gg.w); o8[64 * j] = w; }
}
__device__ __forceinline__ void rms_row_f32_inplace(float* xrow, const float* g, int lane) {
    f32x4* xr = (f32x4*)xrow + lane;
    f32x4 v[8]; float s = 0.f;
#pragma unroll
    for (int j = 0; j < 8; ++j) { v[j] = xr[64 * j]; s += (v[j].x * v[j].x + v[j].y * v[j].y) + (v[j].z * v[j].z + v[j].w * v[j].w); }
    const float rs = 1.0f / sqrtf(wave_sum(s) * (1.f / D_) + EPS_);
    const f32x4* gr = (const f32x4*)g + lane;
#pragma unroll
    for (int j = 0; j < 8; ++j) { const f32x4 gg = gr[64 * j]; xr[64 * j] = v[j] * rs * gg; }
}

constexpr int GL_RS = 528, GL_VS = 272, GL_PS = 144;
constexpr int GL_QE = 0, GL_KI = 33792, GL_G = 67584, GL_V = 101376, GL_P = 118784, GL_TOT = 128000, GL_EL = 132096, GL_SSL = 133120;
static_assert(GL_SSL + 2048 <= LDS_BYTES, "lds");

__device__ __forceinline__ s16x4 tr_read(const LAS unsigned char* p) { return __builtin_bit_cast(s16x4, __builtin_amdgcn_ds_read_tr16_b64_v4i16((LAS s16x4*)p)); }
__device__ __forceinline__ bf16x8 cat8(s16x4 a, s16x4 b) { return (bf16x8){a[0], a[1], a[2], a[3], b[0], b[1], b[2], b[3]}; }

__device__ __forceinline__ void gla_phase(LAS unsigned char* lds, const bf16_t* Qg, const bf16_t* Kg, const bf16_t* Gg, bf16_t* VO, float* SS, int vcu, int G) {
    const int tid = threadIdx.x, w = __builtin_amdgcn_readfirstlane(tid >> 6), lane = tid & 63, fr = lane & 15, fq = lane >> 4;
    const int tq = (lane & 15) >> 2, tp = lane & 3;
    for (int item = vcu; item < 256; item += G) {
        const int es = item & 3, bh = item >> 2, h = bh & 3, b = bh >> 2;
        const size_t mbase = (size_t)b * SEQ_;
        const int srow = tid >> 5, spc = tid & 31, vrow = tid >> 4, vpc = tid & 15;
        const size_t qoff = (mbase + srow) * KW_ + h * 256 + spc * 8;
        const size_t voff = (mbase + vrow) * D_ + h * 512 + es * 128 + vpc * 8;
        u32x4 rq[4], rk[4], rg[4], rv[2];
#pragma unroll
        for (int i = 0; i < 4; ++i) { rq[i] = *(const u32x4*)(Qg + qoff + (size_t)(16 * i) * KW_); rk[i] = *(const u32x4*)(Kg + qoff + (size_t)(16 * i) * KW_); rg[i] = *(const u32x4*)(Gg + qoff + (size_t)(16 * i) * KW_); }
#pragma unroll
        for (int i = 0; i < 2; ++i) rv[i] = *(const u32x4*)(VO + voff + (size_t)(32 * i) * D_);
        f32x4 Sacc[16];
#pragma unroll
        for (int i = 0; i < 16; ++i) Sacc[i] = (f32x4){0.f, 0.f, 0.f, 0.f};

        for (int n = 0; n < 32; ++n) {
#pragma unroll
            for (int i = 0; i < 4; ++i) { const int o = (srow + 16 * i) * GL_RS + spc * 16;
                *(LAS u32x4*)(lds + GL_QE + o) = rq[i]; *(LAS u32x4*)(lds + GL_KI + o) = rk[i]; *(LAS u32x4*)(lds + GL_G + o) = rg[i]; }
#pragma unroll
            for (int i = 0; i < 2; ++i) *(LAS u32x4*)(lds + GL_V + (vrow + 32 * i) * GL_VS + vpc * 16) = rv[i];
            if (n > 0 && tid < 64) { const LAS f32x4* sp = (const LAS f32x4*)(lds + GL_SSL + tid * 32); const f32x4 a = sp[0], c = sp[1];
                SS[(mbase + (size_t)(n - 1) * 64 + tid) * 16 + h * 4 + es] = ((a.x + a.y) + (a.z + a.w)) + ((c.x + c.y) + (c.z + c.w)); }
            if (n + 1 < 32) {
                const size_t adv = (size_t)(n + 1) * 64;
#pragma unroll
                for (int i = 0; i < 4; ++i) { const size_t o = qoff + (adv + 16 * i) * KW_; rq[i] = *(const u32x4*)(Qg + o); rk[i] = *(const u32x4*)(Kg + o); rg[i] = *(const u32x4*)(Gg + o); }
#pragma unroll
                for (int i = 0; i < 2; ++i) rv[i] = *(const u32x4*)(VO + voff + (adv + 32 * i) * D_);
            }
            __syncthreads();
            {
                const int d2 = tid & 127, qt = tid >> 7;
                float c0[16], c1[16]; float a0 = 0.f, a1 = 0.f;
#pragma unroll
                for (int i = 0; i < 16; ++i) { const unsigned gw = *(const LAS unsigned*)(lds + GL_G + (16 * qt + i) * GL_RS + d2 * 4); a0 += bflo(gw); a1 += bfhi(gw); c0[i] = a0; c1[i] = a1; }
                *(LAS f32x2*)(lds + GL_TOT + (qt * 256 + 2 * d2) * 4) = (f32x2){a0, a1};
                __syncthreads();
                float o0 = 0.f, o1 = 0.f;
#pragma unroll
                for (int q = 0; q < 3; ++q) { const f32x2 t = *(const LAS f32x2*)(lds + GL_TOT + (q * 256 + 2 * d2) * 4); if (q < qt) { o0 += t.x; o1 += t.y; } }
#pragma unroll
                for (int i = 0; i < 16; ++i) {
                    const float e0 = __builtin_amdgcn_exp2f(o0 + c0[i]), e1 = __builtin_amdgcn_exp2f(o1 + c1[i]);
                    const float r0 = __builtin_amdgcn_exp2f(-(o0 + c0[i])), r1 = __builtin_amdgcn_exp2f(-(o1 + c1[i]));
                    LAS unsigned* qp = (LAS unsigned*)(lds + GL_QE + (16 * qt + i) * GL_RS + d2 * 4); LAS unsigned* kp = (LAS unsigned*)(lds + GL_KI + (16 * qt + i) * GL_RS + d2 * 4);
                    const unsigned qw = *qp, kw = *kp;
                    *qp = cvtpk(bflo(qw) * e0, bfhi(qw) * e1); *kp = cvtpk(bflo(kw) * r0, bfhi(kw) * r1);
                }
                if (qt == 3) *(LAS f32x2*)(lds + GL_EL + (2 * d2) * 4) = (f32x2){__builtin_amdgcn_exp2f(o0 + c0[15]), __builtin_amdgcn_exp2f(o1 + c1[15])};
                __syncthreads();
            }
            {
                const int tb = w >> 1;
#pragma unroll
                for (int q2 = 0; q2 < 2; ++q2) { const int sb = 2 * (w & 1) + q2;
                    f32x4 sc = {0.f, 0.f, 0.f, 0.f};
                    if (sb <= tb) {
#pragma unroll
                        for (int ks = 0; ks < 8; ++ks) { const bf16x8 a = *(const LAS bf16x8*)(lds + GL_KI + (sb * 16 + fr) * GL_RS + (ks * 32 + fq * 8) * 2);
                            const bf16x8 bq = *(const LAS bf16x8*)(lds + GL_QE + (tb * 16 + fr) * GL_RS + (ks * 32 + fq * 8) * 2);
                            sc = __builtin_amdgcn_mfma_f32_16x16x32_bf16(a, bq, sc, 0, 0, 0); }
                        if (sb == tb) {
#pragma unroll
                            for (int j = 0; j < 4; ++j) if (4 * fq + j > fr) sc[j] = 0.f;
                        }
                    }
                    *(LAS u32x2*)(lds + GL_P + (tb * 16 + fr) * GL_PS + (sb * 16 + 4 * fq) * 2) = (u32x2){cvtpk(sc[0], sc[1]), cvtpk(sc[2], sc[3])};
                }
            }
            f32x4 oacc[4];
#pragma unroll
            for (int i = 0; i < 4; ++i) oacc[i] = (f32x4){0.f, 0.f, 0.f, 0.f};
#pragma unroll
            for (int s8 = 0; s8 < 8; ++s8) {
                const f32x4 x0 = Sacc[2 * s8], x1 = Sacc[2 * s8 + 1];
                const u32x4 sw = {cvtpk(x0[0], x0[1]), cvtpk(x0[2], x0[3]), cvtpk(x1[0], x1[1]), cvtpk(x1[2], x1[3])};
                const bf16x8 sf = __builtin_bit_cast(bf16x8, sw);
#pragma unroll
                for (int tb = 0; tb < 4; ++tb) {
                    const LAS unsigned char* qp = lds + GL_QE + (tb * 16 + fr) * GL_RS + (32 * s8 + 4 * fq) * 2;
                    const s16x4 lo = *(const LAS s16x4*)qp, hi = *(const LAS s16x4*)(qp + 32);
                    oacc[tb] = __builtin_amdgcn_mfma_f32_16x16x32_bf16(sf, cat8(lo, hi), oacc[tb], 0, 0, 0);
                }
            }
            __syncthreads();
            bf16x8 vf[2];
#pragma unroll
            for (int ks = 0; ks < 2; ++ks) { const LAS unsigned char* vp = lds + GL_V + (32 * ks + 8 * fq + tq) * GL_VS + (16 * w + 4 * tp) * 2;
                vf[ks] = cat8(tr_read(vp), tr_read(vp + 4 * GL_VS)); }
#pragma unroll
            for (int ks = 0; ks < 2; ++ks)
#pragma unroll
                for (int tb = 0; tb < 4; ++tb) { const bf16x8 bp = *(const LAS bf16x8*)(lds + GL_P + (tb * 16 + fr) * GL_PS + (32 * ks + 8 * fq) * 2);
                    oacc[tb] = __builtin_amdgcn_mfma_f32_16x16x32_bf16(vf[ks], bp, oacc[tb], 0, 0, 0); }
#pragma unroll
            for (int tb = 0; tb < 4; ++tb) {
                const f32x4 o = oacc[tb];
                float s = (o[0] * o[0] + o[1] * o[1]) + (o[2] * o[2] + o[3] * o[3]);
                s += __shfl_xor(s, 16); s += __shfl_xor(s, 32);
                if (fq == 0) *(LAS float*)(lds + GL_SSL + ((tb * 16 + fr) * 8 + w) * 4) = s;
                *(u32x2*)(VO + (mbase + (size_t)n * 64 + tb * 16 + fr) * D_ + h * 512 + es * 128 + 16 * w + 4 * fq) = (u32x2){cvtpk(o[0], o[1]), cvtpk(o[2], o[3])};
            }
#pragma unroll
            for (int db = 0; db < 16; ++db) {
#pragma unroll
                for (int ks = 0; ks < 2; ++ks) { const LAS unsigned char* kp = lds + GL_KI + (32 * ks + 8 * fq + tq) * GL_RS + (16 * db + 4 * tp) * 2;
                    const bf16x8 a = cat8(tr_read(kp), tr_read(kp + 4 * GL_RS));
                    Sacc[db] = __builtin_amdgcn_mfma_f32_16x16x32_bf16(a, vf[ks], Sacc[db], 0, 0, 0); }
                const f32x4 el = *(const LAS f32x4*)(lds + GL_EL + (16 * db + 4 * fq) * 4);
                Sacc[db] = Sacc[db] * el;
            }
            __syncthreads();
        }
        if (tid < 64) { const LAS f32x4* sp = (const LAS f32x4*)(lds + GL_SSL + tid * 32); const f32x4 a = sp[0], c = sp[1];
            SS[(mbase + (size_t)31 * 64 + tid) * 16 + h * 4 + es] = ((a.x + a.y) + (a.z + a.w)) + ((c.x + c.y) + (c.z + c.w)); }
        __syncthreads();
    }
}

struct Args {
    const float *x, *g_mix, *w_in, *w_gate_up, *b_gate, *g_gla_norm, *w_gla_out, *conv_w, *w_conv_out, *w_o, *g_ffn, *w_ffn_up, *w_ffn_down, *g_final;
    float* out; unsigned char* ws; int ph_lo, ph_hi;
};
constexpr int N_PHASES = 10;

__global__ void __launch_bounds__(512, 2) fwd_megakernel(Args a) {
    extern __shared__ __attribute__((aligned(16))) unsigned char lds_raw[];
    LAS unsigned char* lds = (LAS unsigned char*)lds_raw;
    const int tid = threadIdx.x, lane = tid & 63, wave = __builtin_amdgcn_readfirstlane(tid >> 6);
    const int G = gridDim.x, bx = blockIdx.x;
    const int vcu = (G % 8 == 0) ? (bx % 8) * (G / 8) + bx / 8 : bx;
    const int gw = vcu * 8 + wave, NGW = G * 8;
    unsigned char* ws = a.ws;
    bf16_t* WIN = (bf16_t*)(ws + WS_WIN); bf16_t* WGLA = (bf16_t*)(ws + WS_WGLA); bf16_t* WCONV = (bf16_t*)(ws + WS_WCONV); bf16_t* WO = (bf16_t*)(ws + WS_WO);
    bf16_t* WUP = (bf16_t*)(ws + WS_WUP); bf16_t* WDOWN = (bf16_t*)(ws + WS_WDOWN);
    float* SS = (float*)(ws + WS_SS);
    bf16_t* Hb = (bf16_t*)(ws + WS_H); bf16_t* Qb = (bf16_t*)(ws + WS_Q); bf16_t* Kb = (bf16_t*)(ws + WS_K); bf16_t* Vb = (bf16_t*)(ws + WS_V); bf16_t* Rb = (bf16_t*)(ws + WS_R);
    bf16_t* Gb = (bf16_t*)(ws + WS_G); bf16_t* CBb = (bf16_t*)(ws + WS_CB); bf16_t* Pb = (bf16_t*)(ws + WS_P); bf16_t* MGb = (bf16_t*)(ws + WS_MG); bf16_t* HIDb = (bf16_t*)(ws + WS_HID);
    bf16_t* GAb = (bf16_t*)a.out; bf16_t* GBb = (bf16_t*)a.out + (size_t)M_ * D_;
    const int lo = a.ph_lo, hi = a.ph_hi;
#define IN(k) (lo <= (k) && (k) < hi)
#define SEAM(k) do { if (IN(k) && IN((k) + 1)) cg::this_grid().sync(); } while (0)

    if (IN(0)) {
        LAS float* scr = (LAS float*)(lds + wave * 8448);
        constexpr int I_IN = 32 * (NIN_ / 32), I_SQ = 32 * 64, I_UP = 32 * 256, I_DN = 128 * 64, I_GT = 32 * 32;
        constexpr int NITEMS = I_IN + 3 * I_SQ + I_UP + I_DN + I_GT;
        for (int it = gw; it < NITEMS; it += NGW) {
            int r = it;
            if (r < I_IN) { const int nb = r % (NIN_ / 32), kb = r / (NIN_ / 32); const int sc = win_src_col(nb * 32); if (sc >= 0) transpose_item(a.w_in, INC_, sc, WIN, D_, nb * 32, kb * 64, scr, lane); continue; } r -= I_IN;
            if (r < I_SQ) { transpose_item(a.w_gla_out, D_, (r % 64) * 32, WGLA, D_, (r % 64) * 32, (r / 64) * 64, scr, lane); continue; } r -= I_SQ;
            if (r < I_SQ) { transpose_item(a.w_conv_out, D_, (r % 64) * 32, WCONV, D_, (r % 64) * 32, (r / 64) * 64, scr, lane); continue; } r -= I_SQ;
            if (r < I_SQ) { transpose_item(a.w_o, D_, (r % 64) * 32, WO, D_, (r % 64) * 32, (r / 64) * 64, scr, lane); continue; } r -= I_SQ;
            if (r < I_UP) { transpose_item(a.w_ffn_up, FF_, (r % 256) * 32, WUP, D_, (r % 256) * 32, (r / 256) * 64, scr, lane); continue; } r -= I_UP;
            if (r < I_DN) { transpose_item(a.w_ffn_down, D_, (r % 64) * 32, WDOWN, FF_, (r % 64) * 32, (r / 64) * 64, scr, lane); continue; } r -= I_DN;
            {
                const int nb = r % 32, kb = r / 32, c = lane & 7, k0 = kb * 64 + 8 * c;
#pragma unroll 1
                for (int j = 0; j < 4; ++j) { const int np = nb * 32 + (lane >> 3) + 8 * j; float s[8];
#pragma unroll
                    for (int kk = 0; kk < 8; ++kk) s[kk] = 0.f;
#pragma unroll
                    for (int rr = 0; rr < 16; rr += 4) { float u[4];
#pragma unroll
                        for (int q = 0; q < 4; ++q) u[q] = a.w_gate_up[(size_t)(rr + q) * KW_ + np];
#pragma unroll
                        for (int kk = 0; kk < 8; ++kk) { const f32x4 wv = *(const f32x4*)(a.w_in + (size_t)(k0 + kk) * INC_ + SC_LR + rr); s[kk] += (wv.x * u[0] + wv.y * u[1]) + (wv.z * u[2] + wv.w * u[3]); } }
                    u32x4 o; o.x = cvtpk(s[0], s[1]); o.y = cvtpk(s[2], s[3]); o.z = cvtpk(s[4], s[5]); o.w = cvtpk(s[6], s[7]);
                    *(u32x4*)(WIN + (size_t)(6144 + np) * D_ + k0) = o; }
            }
        }
        for (int m = gw; m < M_; m += NGW) rms_row_bf16(a.x + (size_t)m * D_, a.g_mix, Hb + (size_t)m * D_, lane);
        __syncthreads();
    }
    SEAM(0);
    if (IN(1)) {
        pg8::Gemm g{Hb, WIN, Hb, WIN, D_}; pg8::TileOrder S; S.init(M_, NIN_, G, bx, 1);
        pg8::EpiIn E{Qb, Kb, Vb, Rb, Gb, CBb, Pb, GAb, GBb, a.b_gate};
        pg8::gemm_phase<pg8::EpiIn>(lds, g, S, E);
    }
    SEAM(1);
    if (IN(2)) gla_phase(lds, Qb, Kb, Gb, Vb, SS, vcu, G);
    SEAM(2);
    if (IN(3)) {
        for (int m = gw; m < M_; m += NGW) {
            const f32x4 s0 = *(const f32x4*)(SS + (size_t)m * 16 + 0), s1 = *(const f32x4*)(SS + (size_t)m * 16 + 4), s2 = *(const f32x4*)(SS + (size_t)m * 16 + 8), s3 = *(const f32x4*)(SS + (size_t)m * 16 + 12);
            float rsv[4];
            rsv[0] = 1.0f / sqrtf(((s0.x + s0.y) + (s0.z + s0.w)) * (1.f / 512.f) + EPS_); rsv[1] = 1.0f / sqrtf(((s1.x + s1.y) + (s1.z + s1.w)) * (1.f / 512.f) + EPS_);
            rsv[2] = 1.0f / sqrtf(((s2.x + s2.y) + (s2.z + s2.w)) * (1.f / 512.f) + EPS_); rsv[3] = 1.0f / sqrtf(((s3.x + s3.y) + (s3.z + s3.w)) * (1.f / 512.f) + EPS_);
            const int t = m & (SEQ_ - 1);
#pragma unroll
            for (int i = 0; i < 4; ++i) {
                const int c = 8 * (lane + 64 * i);
                const size_t off = (size_t)m * D_ + c;
                const u32x4 ov = *(const u32x4*)(Vb + off), rv = *(const u32x4*)(Rb + off);
                const f32x4 g0 = *(const f32x4*)(a.g_gla_norm + (c & 511)), g1 = *(const f32x4*)(a.g_gla_norm + (c & 511) + 4);
                const float rs = rsv[i];
                u32x4 o;
                o.x = cvtpk(bflo(ov.x) * rs * g0.x * bflo(rv.x), bfhi(ov.x) * rs * g0.y * bfhi(rv.x));
                o.y = cvtpk(bflo(ov.y) * rs * g0.z * bflo(rv.y), bfhi(ov.y) * rs * g0.w * bfhi(rv.y));
                o.z = cvtpk(bflo(ov.z) * rs * g1.x * bflo(rv.z), bfhi(ov.z) * rs * g1.y * bfhi(rv.z));
                o.w = cvtpk(bflo(ov.w) * rs * g1.z * bflo(rv.w), bfhi(ov.w) * rs * g1.w * bfhi(rv.w));
                *(u32x4*)(Vb + off) = o;
                const u32x4 p2 = *(const u32x4*)(Pb + off);
                u32x4 p1 = {0u, 0u, 0u, 0u}, p0 = {0u, 0u, 0u, 0u};
                if (t >= 1) p1 = *(const u32x4*)(Pb + off - D_);
                if (t >= 2) p0 = *(const u32x4*)(Pb + off - 2 * D_);
                const u32x4 cb = *(const u32x4*)(CBb + off);
                const f32x4 wa0 = *(const f32x4*)(a.conv_w + c), wa1 = *(const f32x4*)(a.conv_w + c + 4);
                const f32x4 wb0 = *(const f32x4*)(a.conv_w + D_ + c), wb1 = *(const f32x4*)(a.conv_w + D_ + c + 4);
                const f32x4 wc0 = *(const f32x4*)(a.conv_w + 2 * D_ + c), wc1 = *(const f32x4*)(a.conv_w + 2 * D_ + c + 4);
                u32x4 y;
#define CV(PW, CW, W0, W1, W2, LOHI_A, LOHI_B) cvtpk(bflo(CW) * (W0.LOHI_A * bflo(p0.PW) + W1.LOHI_A * bflo(p1.PW) + W2.LOHI_A * bflo(p2.PW)), bfhi(CW) * (W0.LOHI_B * bfhi(p0.PW) + W1.LOHI_B * bfhi(p1.PW) + W2.LOHI_B * bfhi(p2.PW)))
                y.x = CV(x, cb.x, wa0, wb0, wc0, x, y);
                y.y = CV(y, cb.y, wa0, wb0, wc0, z, w);
                y.z = CV(z, cb.z, wa1, wb1, wc1, x, y);
                y.w = CV(w, cb.w, wa1, wb1, wc1, z, w);
#undef CV
                *(u32x4*)(CBb + off) = y;
            }
        }
    }
    SEAM(3);
    if (IN(4)) {
        pg8::Gemm g{Vb, WGLA, CBb, WCONV, D_}; pg8::TileOrder S; S.init(M_, D_, G, bx, 2);
        pg8::EpiDual E{GAb, GBb, MGb};
        pg8::gemm_phase<pg8::EpiDual>(lds, g, S, E);
    }
    SEAM(4);
    if (IN(5)) {
        pg8::Gemm g{MGb, WO, MGb, WO, D_}; pg8::TileOrder S; S.init(M_, D_, G, bx, 1);
        pg8::EpiRes E{a.x, a.out};
        pg8::gemm_phase<pg8::EpiRes>(lds, g, S, E);
    }
    SEAM(5);
    if (IN(6)) { for (int m = gw; m < M_; m += NGW) rms_row_bf16(a.out + (size_t)m * D_, a.g_ffn, Hb + (size_t)m * D_, lane); }
    SEAM(6);
    if (IN(7)) {
        pg8::Gemm g{Hb, WUP, Hb, WUP, D_}; pg8::TileOrder S; S.init(M_, FF_, G, bx, 1);
        pg8::EpiUp E{HIDb};
        pg8::gemm_phase<pg8::EpiUp>(lds, g, S, E);
    }
    SEAM(7);
    if (IN(8)) {
        pg8::Gemm g{HIDb, WDOWN, HIDb, WDOWN, FF_}; pg8::TileOrder S; S.init(M_, D_, G, bx, 1);
        pg8::EpiRes E{a.out, a.out};
        pg8::gemm_phase<pg8::EpiRes>(lds, g, S, E);
    }
    SEAM(8);
    if (IN(9)) { for (int m = gw; m < M_; m += NGW) rms_row_f32_inplace(a.out + (size_t)m * D_, a.g_final, lane); }
#undef IN
#undef SEAM
}

extern "C" void kernel_launch(void* const* d_in, const int* in_sizes, int n_in, void* d_out, int out_size, void* d_ws, size_t ws_size, hipStream_t stream) {
    static int grid = 0;
    if (grid == 0) {
        if (n_in != 14 || in_sizes[0] != M_ * D_ || out_size != M_ * D_ || ws_size < WS_NEED) {
            fprintf(stderr, "kernel_launch: unexpected shapes (n_in %d in0 %d out %d ws %zu need %zu); nothing launched\n", n_in, n_in > 0 ? in_sizes[0] : -1, out_size, ws_size, (size_t)WS_NEED); grid = -1; return; }
        int dev = 0, cus = 0, per_cu = 0;
        hipGetDevice(&dev); hipDeviceGetAttribute(&cus, hipDeviceAttributeMultiprocessorCount, dev);
        hipFuncSetAttribute((const void*)fwd_megakernel, hipFuncAttributeMaxDynamicSharedMemorySize, LDS_BYTES);
        hipOccupancyMaxActiveBlocksPerMultiprocessor(&per_cu, (const void*)fwd_megakernel, 512, LDS_BYTES);
        if (per_cu < 1) { fprintf(stderr, "kernel_launch: occupancy query says %d blocks per CU\n", per_cu); per_cu = 1; }
        (void)hipGetLastError();
        grid = cus;
    }
    if (grid < 0) return;
    Args a{};
    a.x = (const float*)d_in[0]; a.g_mix = (const float*)d_in[1]; a.w_in = (const float*)d_in[2]; a.w_gate_up = (const float*)d_in[3]; a.b_gate = (const float*)d_in[4];
    a.g_gla_norm = (const float*)d_in[5]; a.w_gla_out = (const float*)d_in[6]; a.conv_w = (const float*)d_in[7]; a.w_conv_out = (const float*)d_in[8]; a.w_o = (const float*)d_in[9];
    a.g_ffn = (const float*)d_in[10]; a.w_ffn_up = (const float*)d_in[11]; a.w_ffn_down = (const float*)d_in[12]; a.g_final = (const float*)d_in[13];
    a.out = (float*)d_out; a.ws = (unsigned char*)d_ws;
#if MK_SPLIT
    for (int p = 0; p < N_PHASES; ++p) { a.ph_lo = p; a.ph_hi = p + 1; hipLaunchKernelGGL(fwd_megakernel, dim3(grid), dim3(512), LDS_BYTES, stream, a); }
#else
    a.ph_lo = 0; a.ph_hi = N_PHASES;
    void* args[] = {&a};
    hipError_t e = hipLaunchCooperativeKernel((const void*)fwd_megakernel, dim3(grid), dim3(512), args, LDS_BYTES, stream);
    if (e != hipSuccess) fprintf(stderr, "cooperative launch failed: %s (grid %d)\n", hipGetErrorString(e), grid);
#endif
}
```
